# Optimizing an MI355X kernel written in HIP

```python
import jax, jax.numpy as jnp
from jax import lax
import numpy as np

D_MODEL = 1024
BATCH = 8
SEQ = 2048
DEPTH = 1

CONV_WIDTH = D_MODEL
CONV_GROUPS = 8
LRU_WIDTH = D_MODEL
LRU_HEADS = 4
LRU_HEAD_DIM = LRU_WIDTH // LRU_HEADS
SHORT_CONV_K = 3
LRU_CONV_K = 4
FFN_CONV_K = 3
D_FF = 3 * D_MODEL
LRU_C = 8.0
RMS_EPS = 1e-6
IN_COLS = 3 * CONV_WIDTH + 2 * LRU_WIDTH + 2 * D_MODEL
SPLITS = (CONV_WIDTH, 2 * CONV_WIDTH, 3 * CONV_WIDTH,
          3 * CONV_WIDTH + LRU_WIDTH, 3 * CONV_WIDTH + 2 * LRU_WIDTH,
          3 * CONV_WIDTH + 2 * LRU_WIDTH + D_MODEL)

kernel_name = "hybrid_shortconv_rglru_convffn_sandwich"


def rmsnorm(x, g):
    xf = x.astype(jnp.float32)
    y = xf * lax.rsqrt(jnp.mean(xf * xf, axis=-1, keepdims=True) + RMS_EPS)
    return (y * g.astype(jnp.float32)).astype(x.dtype)


def causal_dwconv(x, w, b=None):
    k_width = w.shape[0]
    s = x.shape[1]
    xp = jnp.pad(x, ((0, 0), (k_width - 1, 0), (0, 0)))
    y = xp[:, 0:s] * w[0]
    for k in range(1, k_width):
        y = y + xp[:, k:k + s] * w[k]
    if b is not None:
        y = y + b
    return y


def rg_lru(x, w_a, b_a, w_x, b_x, lam):
    bsz, s, w = x.shape
    xf = x.astype(jnp.float32)
    xh = xf.reshape(bsz, s, LRU_HEADS, LRU_HEAD_DIM)
    r = jax.nn.sigmoid(jnp.einsum("bshi,hij->bshj", xh, w_a.astype(jnp.float32)) + b_a.astype(jnp.float32)).reshape(bsz, s, w)
    i = jax.nn.sigmoid(jnp.einsum("bshi,hij->bshj", xh, w_x.astype(jnp.float32)) + b_x.astype(jnp.float32)).reshape(bsz, s, w)
    log_a = LRU_C * r * jax.nn.log_sigmoid(lam.astype(jnp.float32))
    a = jnp.exp(log_a)
    mult = jnp.sqrt(-jnp.expm1(2.0 * log_a))
    first = (jnp.arange(s) == 0)[None, :, None]
    mult = jnp.where(first, 1.0, mult)
    u = mult * (i * xf)

    def combine(left, right):
        a1, b1 = left
        a2, b2 = right
        return a1 * a2, a2 * b1 + b2

    _, h = lax.associative_scan(combine, (a, u), axis=1)
    return h.astype(x.dtype)


def setup_inputs(seed: int = 0) -> dict:
    key = jax.random.key(seed)
    ks = jax.random.split(key, 24)
    f32 = jnp.float32

    def nrm(k, shape, fan_in):
        return jax.random.normal(k, shape, f32) * (fan_in ** -0.5)

    def gain(k, n):
        return 1.0 + 0.05 * jax.random.normal(k, (DEPTH, n), f32)

    u = jax.random.uniform(ks[14], (DEPTH, LRU_WIDTH), f32, 0.9, 0.999)
    a0 = u ** (1.0 / LRU_C)
    lam = jnp.log(a0) - jnp.log1p(-a0)

    return {
        "x": jax.random.normal(ks[0], (BATCH, SEQ, D_MODEL), f32),
        "norm_mix_pre": gain(ks[1], D_MODEL),
        "norm_mix_post": gain(ks[2], D_MODEL),
        "norm_ffn_pre": gain(ks[3], D_MODEL),
        "norm_ffn_post": gain(ks[4], D_MODEL),
        "w_in": nrm(ks[5], (DEPTH, D_MODEL, IN_COLS), D_MODEL),
        "conv_short_w": nrm(ks[6], (DEPTH, SHORT_CONV_K, CONV_WIDTH), SHORT_CONV_K),
        "w_conv_branch": nrm(ks[7], (DEPTH, CONV_WIDTH, D_MODEL), CONV_WIDTH),
        "lru_conv_w": nrm(ks[8], (DEPTH, LRU_CONV_K, LRU_WIDTH), LRU_CONV_K),
        "lru_conv_b": 0.02 * jax.random.normal(ks[9], (DEPTH, LRU_WIDTH), f32),
        "lru_wa": nrm(ks[10], (DEPTH, LRU_HEADS, LRU_HEAD_DIM, LRU_HEAD_DIM), LRU_HEAD_DIM),
        "lru_ba": 0.02 * jax.random.normal(ks[11], (DEPTH, LRU_HEADS, LRU_HEAD_DIM), f32),
        "lru_wx": nrm(ks[12], (DEPTH, LRU_HEADS, LRU_HEAD_DIM, LRU_HEAD_DIM), LRU_HEAD_DIM),
        "lru_bx": 0.02 * jax.random.normal(ks[13], (DEPTH, LRU_HEADS, LRU_HEAD_DIM), f32),
        "lru_lambda": lam,
        "w_lru_branch": nrm(ks[15], (DEPTH, LRU_WIDTH, D_MODEL), LRU_WIDTH),
        "w_out": nrm(ks[16], (DEPTH, D_MODEL, D_MODEL), D_MODEL),
        "ffn_w_up": nrm(ks[17], (DEPTH, D_MODEL, 2 * D_FF), D_MODEL),
        "ffn_conv_w": nrm(ks[18], (DEPTH, FFN_CONV_K, 2 * D_FF), FFN_CONV_K),
        "ffn_conv_b": 0.02 * jax.random.normal(ks[19], (DEPTH, 2 * D_FF), f32),
        "ffn_w_down": nrm(ks[20], (DEPTH, D_FF, D_MODEL), D_FF),
    }


def reference(x, norm_mix_pre, norm_mix_post, norm_ffn_pre, norm_ffn_post, w_in, conv_short_w,
              w_conv_branch, lru_conv_w, lru_conv_b, lru_wa, lru_ba, lru_wx, lru_bx, lru_lambda,
              w_lru_branch, w_out, ffn_w_up, ffn_conv_w, ffn_conv_b, ffn_w_down):
    for l in range(DEPTH):
        h = rmsnorm(x, norm_mix_pre[l])
        proj = jnp.einsum("bsd,dc->bsc", h, w_in[l])
        c_b, c_c, c_x, l_x, l_y, g_conv, g_lru = jnp.split(proj, SPLITS, axis=-1)
        y_a = c_b * causal_dwconv(c_c * c_x, conv_short_w[l])
        xl = causal_dwconv(l_x, lru_conv_w[l], lru_conv_b[l])
        hl = rg_lru(xl, lru_wa[l], lru_ba[l], lru_wx[l], lru_bx[l], lru_lambda[l])
        y_b = hl * jax.nn.gelu(l_y, approximate=True)
        merged = (jax.nn.sigmoid(g_conv) * jnp.einsum("bsc,cd->bsd", y_a, w_conv_branch[l])
                  + jax.nn.sigmoid(g_lru) * jnp.einsum("bsc,cd->bsd", y_b, w_lru_branch[l]))
        mix = jnp.einsum("bsd,de->bse", merged, w_out[l])
        x = x + rmsnorm(mix, norm_mix_post[l])
        h = rmsnorm(x, norm_ffn_pre[l])
        up = jnp.einsum("bsd,df->bsf", h, ffn_w_up[l])
        up = causal_dwconv(up, ffn_conv_w[l], ffn_conv_b[l])
        gate, val = jnp.split(up, 2, axis=-1)
        f = jax.nn.gelu(gate, approximate=True) * val
        out = jnp.einsum("bsf,fd->bsd", f, ffn_w_down[l])
        x = x + rmsnorm(out, norm_ffn_post[l])
    return x
```

```cpp
#include <hip/hip_runtime.h>
#include <cstdio>
#include <cstdint>

namespace nv {
constexpr int D = 1024, BATCH = 8, SEQ = 2048, NIN = 7168, DFF = 3072, M = BATCH * SEQ;
constexpr float EPS = 1e-6f;

__device__ __forceinline__ float gelu_tanh(float x) { return 0.5f * x * (1.f + tanhf(0.7978845608028654f * (x + 0.044715f * x * x * x))); }
__device__ __forceinline__ float sigmoidf(float x) { return 1.f / (1.f + expf(-x)); }
__device__ __forceinline__ float log_sigmoidf(float x) { return fminf(x, 0.f) - log1pf(expf(-fabsf(x))); }

__global__ void k_rmsnorm(const float* __restrict__ x, const float* __restrict__ g, float* __restrict__ out) {
    __shared__ float red[4];
    const int r = blockIdx.x, t = threadIdx.x;
    const float4 v = ((const float4*)(x + (size_t)r * D))[t];
    float s = v.x * v.x + v.y * v.y + v.z * v.z + v.w * v.w;
    for (int o = 32; o > 0; o >>= 1) s += __shfl_xor(s, o);
    if ((t & 63) == 0) red[t >> 6] = s;
    __syncthreads();
    const float tot = red[0] + red[1] + red[2] + red[3];
    const float rs = rsqrtf(tot * (1.f / D) + EPS);
    const float4 gg = ((const float4*)g)[t];
    float4 o; o.x = v.x * rs * gg.x; o.y = v.y * rs * gg.y; o.z = v.z * rs * gg.z; o.w = v.w * rs * gg.w;
    ((float4*)(out + (size_t)r * D))[t] = o;
}
__global__ void k_res_rmsnorm(const float* base, const float* __restrict__ y, const float* __restrict__ g, float* out) {
    __shared__ float red[4];
    const int r = blockIdx.x, t = threadIdx.x;
    const float4 v = ((const float4*)(y + (size_t)r * D))[t];
    float s = v.x * v.x + v.y * v.y + v.z * v.z + v.w * v.w;
    for (int o = 32; o > 0; o >>= 1) s += __shfl_xor(s, o);
    if ((t & 63) == 0) red[t >> 6] = s;
    __syncthreads();
    const float tot = red[0] + red[1] + red[2] + red[3];
    const float rs = rsqrtf(tot * (1.f / D) + EPS);
    const float4 gg = ((const float4*)g)[t];
    const float4 b = ((const float4*)(base + (size_t)r * D))[t];
    float4 o; o.x = b.x + v.x * rs * gg.x; o.y = b.y + v.y * rs * gg.y; o.z = b.z + v.z * rs * gg.z; o.w = b.w + v.w * rs * gg.w;
    ((float4*)(out + (size_t)r * D))[t] = o;
}

__global__ void __launch_bounds__(256) k_gemm(const float* __restrict__ A, int lda, const float* __restrict__ W, int ldw, float* __restrict__ C, int ldc, int K) {
    __shared__ float As[16][64 + 4];
    __shared__ float Ws[16][64 + 4];
    const int tid = threadIdx.x, tx = tid & 15, ty = tid >> 4;
    const int m0 = blockIdx.y * 64, n0 = blockIdx.x * 64;
    float acc[4][4] = {};
    for (int k0 = 0; k0 < K; k0 += 16) {
        {
            const int r = tid >> 2, c = (tid & 3) * 4;
            const float4 v = *(const float4*)(A + (size_t)(m0 + r) * lda + k0 + c);
            As[c + 0][r] = v.x; As[c + 1][r] = v.y; As[c + 2][r] = v.z; As[c + 3][r] = v.w;
        }
        {
            const int r = tid >> 4, c = (tid & 15) * 4;
            const float4 v = *(const float4*)(W + (size_t)(k0 + r) * ldw + n0 + c);
            *(float4*)&Ws[r][c] = v;
        }
        __syncthreads();
#pragma unroll
        for (int k = 0; k < 16; ++k) {
            const float4 a = *(const float4*)&As[k][ty * 4];
            const float4 w = *(const float4*)&Ws[k][tx * 4];
            const float av[4] = {a.x, a.y, a.z, a.w}, wv[4] = {w.x, w.y, w.z, w.w};
#pragma unroll
            for (int i = 0; i < 4; ++i)
#pragma unroll
                for (int j = 0; j < 4; ++j) acc[i][j] += av[i] * wv[j];
        }
        __syncthreads();
    }
#pragma unroll
    for (int i = 0; i < 4; ++i) {
        float4 o; o.x = acc[i][0]; o.y = acc[i][1]; o.z = acc[i][2]; o.w = acc[i][3];
        *(float4*)(C + (size_t)(m0 + ty * 4 + i) * ldc + n0 + tx * 4) = o;
    }
}

__global__ void k_mix_elem(const float* __restrict__ proj, const float* __restrict__ cw  , const float* __restrict__ lw  , const float* __restrict__ lb,
                           float* __restrict__ ya, float* __restrict__ xl) {
    const int idx = blockIdx.x * blockDim.x + threadIdx.x; if (idx >= SEQ * D) return;
    const int t = idx / D, c = idx % D;
    float conv = 0.f;
#pragma unroll
    for (int k = 0; k < 3; ++k) { const int tt = t - 2 + k; if (tt >= 0) { const float* p = proj + (size_t)tt * NIN; conv += p[D + c] * p[2 * D + c] * cw[k * D + c]; } }
    ya[idx] = proj[(size_t)t * NIN + c] * conv;
    float x4 = lb[c];
#pragma unroll
    for (int k = 0; k < 4; ++k) { const int tt = t - 3 + k; if (tt >= 0) x4 += proj[(size_t)tt * NIN + 3 * D + c] * lw[k * D + c]; }
    xl[idx] = x4;
}
__global__ void k_scan(const float* __restrict__ xl, const float* __restrict__ rr, const float* __restrict__ ii, const float* __restrict__ ba, const float* __restrict__ bx,
                       const float* __restrict__ lam, const float* __restrict__ proj, float* __restrict__ yb) {
    const int c = blockIdx.x * blockDim.x + threadIdx.x; if (c >= D) return;
    const float ls = log_sigmoidf(lam[c]), bac = ba[c], bxc = bx[c];
    float h = 0.f;
    for (int t = 0; t < SEQ; ++t) {
        const float x = xl[(size_t)t * D + c];
        const float r = sigmoidf(rr[(size_t)t * D + c] + bac), i = sigmoidf(ii[(size_t)t * D + c] + bxc);
        const float log_a = 8.0f * r * ls;
        const float a = expf(log_a);
        float mult = sqrtf(-expm1f(2.0f * log_a)); if (t == 0) mult = 1.f;
        h = a * h + mult * (i * x);
        yb[(size_t)t * D + c] = h * gelu_tanh(proj[(size_t)t * NIN + 4 * D + c]);
    }
}
__global__ void k_merge(const float* __restrict__ proj, const float* __restrict__ m1, const float* __restrict__ m2, float* __restrict__ mg) {
    const int idx = blockIdx.x * blockDim.x + threadIdx.x; if (idx >= SEQ * D) return;
    const int t = idx / D, c = idx % D;
    mg[idx] = sigmoidf(proj[(size_t)t * NIN + 5 * D + c]) * m1[idx] + sigmoidf(proj[(size_t)t * NIN + 6 * D + c]) * m2[idx];
}
__global__ void k_ffn_elem(const float* __restrict__ up, const float* __restrict__ fw  , const float* __restrict__ fb, float* __restrict__ f) {
    const int idx = blockIdx.x * blockDim.x + threadIdx.x; if (idx >= SEQ * DFF) return;
    const int t = idx / DFF, j = idx % DFF;
    float g = fb[j], v = fb[DFF + j];
#pragma unroll
    for (int k = 0; k < 3; ++k) { const int tt = t - 2 + k; if (tt >= 0) { g += up[(size_t)tt * 2 * DFF + j] * fw[k * 2 * DFF + j]; v += up[(size_t)tt * 2 * DFF + DFF + j] * fw[k * 2 * DFF + DFF + j]; } }
    f[idx] = gelu_tanh(g) * v;
}
}

extern "C" void kernel_launch(void* const* d_in, const int* in_sizes, int n_in, void* d_out, int out_size, void* d_ws, size_t ws_size, hipStream_t stream) {
    using namespace nv;
    const float* x = (const float*)d_in[0];
    const float *g1 = (const float*)d_in[1], *g2 = (const float*)d_in[2], *g3 = (const float*)d_in[3], *g4 = (const float*)d_in[4];
    const float* w_in = (const float*)d_in[5]; const float* csw = (const float*)d_in[6]; const float* wcb = (const float*)d_in[7];
    const float* lcw = (const float*)d_in[8]; const float* lcb = (const float*)d_in[9];
    const float* wa = (const float*)d_in[10]; const float* ba = (const float*)d_in[11]; const float* wx = (const float*)d_in[12]; const float* bx = (const float*)d_in[13];
    const float* lam = (const float*)d_in[14]; const float* wlb = (const float*)d_in[15]; const float* wout = (const float*)d_in[16];
    const float* wup = (const float*)d_in[17]; const float* fcw = (const float*)d_in[18]; const float* fcb = (const float*)d_in[19]; const float* wdn = (const float*)d_in[20];
    float* out = (float*)d_out;
    float* ws = (float*)d_ws;
    const size_t SD = (size_t)SEQ * D;
    float* hn = ws;
    float* proj = hn + SD;
    float* ya = proj + (size_t)SEQ * NIN;
    float* xl = ya + SD; float* rr = xl + SD; float* ii = rr + SD; float* yb = ii + SD; float* m1 = yb + SD; float* m2 = m1 + SD; float* mg = m2 + SD; float* mix = mg + SD;
    float* hn2 = mix + SD; float* up = hn2 + SD;   float* f = up + (size_t)SEQ * 2 * DFF;   float* o2 = f + (size_t)SEQ * DFF;
    for (int b = 0; b < BATCH; ++b) {
        const float* xb = x + (size_t)b * SD; float* ob = out + (size_t)b * SD;
        k_rmsnorm<<<SEQ, 256, 0, stream>>>(xb, g1, hn);
        k_gemm<<<dim3(NIN / 64, SEQ / 64), 256, 0, stream>>>(hn, D, w_in, NIN, proj, NIN, D);
        k_mix_elem<<<SEQ * D / 256, 256, 0, stream>>>(proj, csw, lcw, lcb, ya, xl);
        for (int h = 0; h < 4; ++h) {
            k_gemm<<<dim3(256 / 64, SEQ / 64), 256, 0, stream>>>(xl + h * 256, D, wa + (size_t)h * 65536, 256, rr + h * 256, D, 256);
            k_gemm<<<dim3(256 / 64, SEQ / 64), 256, 0, stream>>>(xl + h * 256, D, wx + (size_t)h * 65536, 256, ii + h * 256, D, 256);
        }
        k_scan<<<D / 64, 64, 0, stream>>>(xl, rr, ii, ba, bx, lam, proj, yb);
        k_gemm<<<dim3(D / 64, SEQ / 64), 256, 0, stream>>>(ya, D, wcb, D, m1, D, D);
        k_gemm<<<dim3(D / 64, SEQ / 64), 256, 0, stream>>>(yb, D, wlb, D, m2, D, D);
        k_merge<<<SEQ * D / 256, 256, 0, stream>>>(proj, m1, m2, mg);
        k_gemm<<<dim3(D / 64, SEQ / 64), 256, 0, stream>>>(mg, D, wout, D, mix, D, D);
        k_res_rmsnorm<<<SEQ, 256, 0, stream>>>(xb, mix, g2, ob);
        k_rmsnorm<<<SEQ, 256, 0, stream>>>(ob, g3, hn2);
        k_gemm<<<dim3(2 * DFF / 64, SEQ / 64), 256, 0, stream>>>(hn2, D, wup, 2 * DFF, up, 2 * DFF, D);
        k_ffn_elem<<<SEQ * DFF / 256, 256, 0, stream>>>(up, fcw, fcb, f);
        k_gemm<<<dim3(D / 64, SEQ / 64), 256, 0, stream>>>(f, DFF, wdn, D, o2, D, DFF);
        k_res_rmsnorm<<<SEQ, 256, 0, stream>>>(ob, o2, g4, ob);
    }
}
```
